# Optimizing an MI355X kernel written in HIP

```python
import jax, jax.numpy as jnp
from jax import lax
import numpy as np

D_MODEL = 2048
BATCH = 1
SEQ = 8192
DEPTH = 4

N_MIXERS = 4
GROUP_WIDTH = D_MODEL // N_MIXERS
HEAD_DIM = 128
HEADS_PER_GROUP = GROUP_WIDTH // HEAD_DIM
D_FF = 5632
CONV_WIDTH = 3
POOL_WINDOWS = (2, 4, 8, 16)
POOL_GROUPS = len(POOL_WINDOWS)
POOL_GROUP_WIDTH = GROUP_WIDTH // POOL_GROUPS
MLSTM_CHUNK = 128
SB_BLOCK = 128
NORM_EPS = 1e-6

_COL_SIZES = (GROUP_WIDTH,) * 3 + (GROUP_WIDTH,) * 4 + (HEADS_PER_GROUP,) * 2 + (GROUP_WIDTH,) + (GROUP_WIDTH,) * 3
D_IN_PROJ = sum(_COL_SIZES)
SPLIT_POINTS = tuple(int(s) for s in np.cumsum(_COL_SIZES)[:-1])

kernel_name = "hymba_style_parallel_hybrid_macaron"


def rms_norm(x, g):
    xf = x.astype(jnp.float32)
    y = xf * lax.rsqrt(jnp.mean(xf * xf, axis=-1, keepdims=True) + NORM_EPS)
    return (y * g.astype(jnp.float32)).astype(x.dtype)


def swiglu(x, w_gate, w_up, w_down):
    return (jax.nn.silu(x @ w_gate) * (x @ w_up)) @ w_down


def short_conv_mixer(b, c, u, conv_w):
    z = c * u
    y = lax.conv_general_dilated(
        z, conv_w[:, None, :].astype(z.dtype), window_strides=(1,),
        padding=((CONV_WIDTH - 1, 0),), dimension_numbers=('NWC', 'WIO', 'NWC'),
        feature_group_count=z.shape[-1])
    return b * y


def mlstm_mixer(q, k, v, i_pre, f_pre, o_pre, head_gain):
    B_, S, H, dh = q.shape
    L = MLSTM_CHUNK
    NC = S // L
    f32 = jnp.float32
    qf = q.astype(f32)
    kf = k.astype(f32) * (dh ** -0.5)
    vf = v.astype(f32)
    log_f = jax.nn.log_sigmoid(f_pre.astype(f32))
    i_g = i_pre.astype(f32)

    def to_chunks(a):
        return a.reshape(B_, NC, L, H, -1).transpose(1, 0, 3, 2, 4)

    def gate_chunks(a):
        return a.reshape(B_, NC, L, H).transpose(1, 0, 3, 2)

    causal = jnp.tril(jnp.ones((L, L), dtype=bool))

    def step(carry, inp):
        C, n, m = carry
        qb, kb, vb, lf, ig = inp
        b = jnp.cumsum(lf, axis=-1)
        D = jnp.where(causal, b[..., :, None] - b[..., None, :] + ig[..., None, :], -jnp.inf)
        inter = b + m[..., None]
        m_t = jnp.maximum(inter, jnp.max(D, axis=-1))
        w_intra = jnp.exp(D - m_t[..., None])
        w_inter = jnp.exp(inter - m_t)
        s = jnp.einsum('bhtd,bhsd->bhts', qb, kb) * w_intra
        num = jnp.einsum('bhts,bhsd->bhtd', s, vb) + w_inter[..., None] * jnp.einsum('bhtd,bhde->bhte', qb, C)
        den = jnp.sum(s, axis=-1) + w_inter * jnp.einsum('bhtd,bhd->bht', qb, n)
        h = num / jnp.maximum(jnp.abs(den), jnp.exp(-m_t))[..., None]
        b_last = b[..., -1]
        g = b_last[..., None] - b + ig
        m_new = jnp.maximum(b_last + m, jnp.max(g, axis=-1))
        decay = jnp.exp(b_last + m - m_new)
        wk = jnp.exp(g - m_new[..., None])
        C_new = decay[..., None, None] * C + jnp.einsum('bhs,bhsd,bhse->bhde', wk, kb, vb)
        n_new = decay[..., None] * n + jnp.einsum('bhs,bhsd->bhd', wk, kb)
        return (C_new, n_new, m_new), h

    init = (jnp.zeros((B_, H, dh, dh), f32), jnp.zeros((B_, H, dh), f32), jnp.zeros((B_, H), f32))
    _, hs = lax.scan(step, init, (to_chunks(qf), to_chunks(kf), to_chunks(vf), gate_chunks(log_f), gate_chunks(i_g)))
    h = hs.transpose(1, 0, 3, 2, 4).reshape(B_, S, H, dh)
    h = h * lax.rsqrt(jnp.mean(h * h, axis=-1, keepdims=True) + NORM_EPS)
    h = h.reshape(B_, S, H * dh) * head_gain.astype(f32)
    return (jax.nn.sigmoid(o_pre.astype(f32)) * h).astype(q.dtype)


def pool_mixer(u, pool_w, pool_scale):
    B_, S, _ = u.shape
    f32 = jnp.float32
    uf = u.astype(f32).reshape(B_, S, POOL_GROUPS, POOL_GROUP_WIDTH)
    cs = jnp.pad(jnp.cumsum(uf, axis=1), ((0, 0), (1, 0), (0, 0), (0, 0)))
    t = jnp.arange(S)
    win = jnp.array(POOL_WINDOWS, dtype=jnp.int32)
    lo = jnp.maximum(t[:, None] + 1 - win[None, :], 0)
    grp = jnp.arange(POOL_GROUPS)[None, :]
    window_sum = cs[:, 1:] - cs[:, lo, grp]
    count = (t[:, None] + 1 - lo).astype(f32)
    pooled = window_sum / count[None, :, :, None] - uf
    y = jnp.einsum('bsgc,gcd->bsgd', pooled, pool_w.astype(f32)).reshape(B_, S, GROUP_WIDTH)
    return (y * pool_scale.astype(f32)).astype(u.dtype)


def stick_breaking_mixer(q, k, v):
    B_, S, H, dh = q.shape
    NB = S // SB_BLOCK
    f32 = jnp.float32
    qf = q.astype(f32) * (dh ** -0.5)
    kf = k.astype(f32)
    vf = v.astype(f32)
    q_blocks = qf.reshape(B_, NB, SB_BLOCK, H, dh).transpose(1, 0, 3, 2, 4)
    key_pos = jnp.arange(S)

    def block(args):
        q_blk, blk = args
        q_pos = blk * SB_BLOCK + jnp.arange(SB_BLOCK)
        z = jnp.einsum('bhqd,bshd->bhqs', q_blk, kf)
        past = key_pos[None, :] < q_pos[:, None]
        log_1m_beta = jnp.where(past, jax.nn.log_sigmoid(-z), 0.0)
        rest = lax.cumsum(log_1m_beta, axis=3, reverse=True) - log_1m_beta
        A = jnp.where(past, jnp.exp(jax.nn.log_sigmoid(z) + rest), 0.0)
        return jnp.einsum('bhqs,bshd->bqhd', A, vf)

    out = lax.map(block, (q_blocks, jnp.arange(NB)))
    return out.transpose(1, 0, 2, 3, 4).reshape(B_, S, H * dh).astype(q.dtype)


def token_mix(h, w_in, w_out, conv_w, pool_w, pool_scale, i_bias, f_bias, head_gain):
    B_, S, _ = h.shape
    proj = h @ w_in
    (cb, cc, cu, mq, mk, mv, mo, mi, mf, pu, sq, sk, sv) = jnp.split(proj, SPLIT_POINTS, axis=-1)

    def heads(a):
        return a.reshape(B_, S, HEADS_PER_GROUP, HEAD_DIM)

    y_conv = short_conv_mixer(cb, cc, cu, conv_w)
    y_mlstm = mlstm_mixer(heads(mq), heads(mk), heads(mv), mi + i_bias, mf + f_bias, mo, head_gain)
    y_pool = pool_mixer(pu, pool_w, pool_scale)
    y_sb = stick_breaking_mixer(heads(sq), heads(sk), heads(sv))
    y = jnp.concatenate([y_conv.astype(h.dtype), y_mlstm.astype(h.dtype),
                         y_pool.astype(h.dtype), y_sb.astype(h.dtype)], axis=-1)
    return y @ w_out


def setup_inputs(seed: int = 0) -> dict:
    key = jax.random.key(seed)
    ks = jax.random.split(key, 17)
    f32 = jnp.float32
    G, H = GROUP_WIDTH, HEADS_PER_GROUP
    nrm = lambda k, shape, scale: jax.random.normal(k, shape, f32) * scale
    return {
        "x": nrm(ks[0], (BATCH, SEQ, D_MODEL), 1.0),
        "w_in": nrm(ks[1], (DEPTH, D_MODEL, D_IN_PROJ), D_MODEL ** -0.5),
        "w_out": nrm(ks[2], (DEPTH, D_MODEL, D_MODEL), D_MODEL ** -0.5),
        "conv_w": nrm(ks[3], (DEPTH, CONV_WIDTH, G), CONV_WIDTH ** -0.5),
        "pool_w": nrm(ks[4], (DEPTH, POOL_GROUPS, POOL_GROUP_WIDTH, POOL_GROUP_WIDTH), POOL_GROUP_WIDTH ** -0.5),
        "pool_scale": 1.0 + nrm(ks[5], (DEPTH, G), 0.02),
        "mlstm_i_bias": nrm(ks[6], (DEPTH, H), 0.1),
        "mlstm_f_bias": 3.0 + 3.0 * jax.random.uniform(ks[7], (DEPTH, H), f32),
        "mlstm_head_gain": 1.0 + nrm(ks[8], (DEPTH, G), 0.02),
        "ffn1_w_gate": nrm(ks[9], (DEPTH, D_MODEL, D_FF), D_MODEL ** -0.5),
        "ffn1_w_up": nrm(ks[10], (DEPTH, D_MODEL, D_FF), D_MODEL ** -0.5),
        "ffn1_w_down": nrm(ks[11], (DEPTH, D_FF, D_MODEL), D_FF ** -0.5),
        "ffn2_w_gate": nrm(ks[12], (DEPTH, D_MODEL, D_FF), D_MODEL ** -0.5),
        "ffn2_w_up": nrm(ks[13], (DEPTH, D_MODEL, D_FF), D_MODEL ** -0.5),
        "ffn2_w_down": nrm(ks[14], (DEPTH, D_FF, D_MODEL), D_FF ** -0.5),
        "norm_gains": 1.0 + nrm(ks[15], (DEPTH, 6, D_MODEL), 0.02),
    }


def reference(x, w_in, w_out, conv_w, pool_w, pool_scale, mlstm_i_bias, mlstm_f_bias, mlstm_head_gain,
              ffn1_w_gate, ffn1_w_up, ffn1_w_down, ffn2_w_gate, ffn2_w_up, ffn2_w_down, norm_gains):
    for l in range(DEPTH):
        g = norm_gains[l]
        h = rms_norm(x, g[0])
        x = x + 0.5 * rms_norm(swiglu(h, ffn1_w_gate[l], ffn1_w_up[l], ffn1_w_down[l]), g[1])
        h = rms_norm(x, g[2])
        y = token_mix(h, w_in[l], w_out[l], conv_w[l], pool_w[l], pool_scale[l],
                      mlstm_i_bias[l], mlstm_f_bias[l], mlstm_head_gain[l])
        x = x + rms_norm(y, g[3])
        h = rms_norm(x, g[4])
        x = x + 0.5 * rms_norm(swiglu(h, ffn2_w_gate[l], ffn2_w_up[l], ffn2_w_down[l]), g[5])
    return x
```

```cpp
#include <hip/hip_runtime.h>
#include <cstdio>
#include <cstdint>
namespace pg8 {
#define PG8_LAS __attribute__((address_space(3)))
typedef unsigned short bf16_t;
typedef short bf16x8 __attribute__((ext_vector_type(8)));
typedef float f32x4 __attribute__((ext_vector_type(4)));
typedef unsigned u32x4 __attribute__((ext_vector_type(4)));
constexpr int BM = 256, BK = 64, HALF = 128, HTB = HALF * BK * 2  , STAGE_BYTES = 8 * HTB, NXCD = 8, WGM = 8;

__host__ __device__ __forceinline__ int lds_byte(int r, int c) { const int st = (r >> 4) * 2 + (c >> 5), rr = r & 15, cc = c & 31, ob = rr * 64 + cc * 2; return st * 1024 + (ob ^ (((ob >> 9) & 1) << 5)); }
__host__ __device__ __forceinline__ void stage_rc(int b, int& R, int& C) { const int st = b / 1024, sb = b % 1024, swz = sb ^ (((sb >> 9) & 1) << 5); R = (st >> 1) * 16 + swz / 64; C = (st & 1) * 32 + (swz % 64) / 2; }
__host__ __device__ __forceinline__ int perm32(int rho) { const int n = rho >> 4, i = rho & 15; return 8 * (i >> 2) + 4 * n + (i & 3); }

struct Unit { int pm, pn; };
struct Gemm { const bf16_t* A; const bf16_t* Bt; int M, N, K; };

struct StaticOrder {
    int nM, nN, nwg, G, c;
    __host__ __device__ void init(int M, int N, int G_, int c_) { nM = M / BM; nN = N / BM; nwg = nM * nN; G = G_; c = c_; }
    __host__ __device__ bool next(int i, Unit& u) const {
        const long L = (long)i * G + c; if (L >= nwg) return false;
        int wgid = (int)L; { const int q = nwg / NXCD, r = nwg % NXCD, xcd = wgid % NXCD, off = wgid / NXCD; wgid = (xcd < r ? xcd * (q + 1) : r * (q + 1) + (xcd - r) * q) + off; }
        const int nig = WGM * nN, gid = wgid / nig, fm = gid * WGM, gsz = (nM - fm) < WGM ? (nM - fm) : WGM;
        u.pm = fm + ((wgid % nig) % gsz); u.pn = (wgid % nig) / gsz; return true;
    }
    __device__ __forceinline__ void a_ready(const Unit&) const {}
    __device__ __forceinline__ void done(const Unit&) const {}
};

__device__ __forceinline__ unsigned cvt_pk_bf16(float lo, float hi) { unsigned r; asm volatile("v_cvt_pk_bf16_f32 %0, %1, %2" : "=v"(r) : "v"(lo), "v"(hi)); return r; }
typedef float f32x2 __attribute__((ext_vector_type(2)));
struct EpiF32 {
    static constexpr bool PERM = false, AFTER_DRAIN = false;
    float* C; int ldc;
    __device__ __forceinline__ void operator()(const f32x4 (&acc)[2][2][4][2], const Unit& u, int wr, int wc, int fr, int fq) const {
        const int row0 = u.pm * BM + wr * 64 + fr, col0 = u.pn * BM + wc * 32 + 4 * fq;
#pragma unroll
        for (int ai = 0; ai < 2; ++ai)
#pragma unroll
            for (int m = 0; m < 4; ++m) { float* rowp = C + (size_t)(row0 + ai * HALF + m * 16) * ldc + col0;
#pragma unroll
                for (int bj = 0; bj < 2; ++bj)
#pragma unroll
                    for (int n = 0; n < 2; ++n) *(f32x4*)(rowp + bj * HALF + n * 16) = acc[ai][bj][m][n]; }
    }
};
struct EpiBf16 {
    static constexpr bool PERM = true, AFTER_DRAIN = false;
    bf16_t* O; int ldc;
    __device__ __forceinline__ void operator()(const f32x4 (&acc)[2][2][4][2], const Unit& u, int wr, int wc, int fr, int fq) const {
        const int row0 = u.pm * BM + wr * 64 + fr, col0 = u.pn * BM + wc * 32 + 8 * fq;
#pragma unroll
        for (int ai = 0; ai < 2; ++ai)
#pragma unroll
            for (int m = 0; m < 4; ++m) { bf16_t* rowp = O + (size_t)(row0 + ai * HALF + m * 16) * ldc + col0;
#pragma unroll
                for (int bj = 0; bj < 2; ++bj) { const f32x4 v0 = acc[ai][bj][m][0], v1 = acc[ai][bj][m][1];
                    u32x4 w; w.x = cvt_pk_bf16(v0[0], v0[1]); w.y = cvt_pk_bf16(v0[2], v0[3]); w.z = cvt_pk_bf16(v1[0], v1[1]); w.w = cvt_pk_bf16(v1[2], v1[3]);
                    *(u32x4*)(rowp + bj * HALF) = w; } }
    }
};
__device__ __forceinline__ float silu_f(float g) { return g * __builtin_amdgcn_rcpf(1.0f + __builtin_amdgcn_exp2f(-1.4426950408889634f * g)); }
struct EpiSwiglu {
    static constexpr bool PERM = true, AFTER_DRAIN = false;
    bf16_t* O; int ldc;
    __device__ __forceinline__ void operator()(const f32x4 (&acc)[2][2][4][2], const Unit& u, int wr, int wc, int fr, int fq) const {
        const int row0 = u.pm * BM + wr * 64 + fr, col0 = u.pn * HALF + wc * 32 + 8 * fq;
#pragma unroll
        for (int ai = 0; ai < 2; ++ai)
#pragma unroll
            for (int m = 0; m < 4; ++m) { bf16_t* rowp = O + (size_t)(row0 + ai * HALF + m * 16) * ldc + col0;
                const f32x4 g0 = acc[ai][0][m][0], g1 = acc[ai][0][m][1], u0 = acc[ai][1][m][0], u1 = acc[ai][1][m][1];
                u32x4 w; w.x = cvt_pk_bf16(silu_f(g0[0]) * u0[0], silu_f(g0[1]) * u0[1]); w.y = cvt_pk_bf16(silu_f(g0[2]) * u0[2], silu_f(g0[3]) * u0[3]);
                w.z = cvt_pk_bf16(silu_f(g1[0]) * u1[0], silu_f(g1[1]) * u1[1]); w.w = cvt_pk_bf16(silu_f(g1[2]) * u1[2], silu_f(g1[3]) * u1[3]);
                *(u32x4*)rowp = w; }
    }
};

template <class Epi, class Sched, bool ALIGN_EPI = false, bool SP2 = false>
__device__ __forceinline__ void gemm_phase(PG8_LAS unsigned char* lds, const Gemm g, const Sched& S, const Epi& E) {
    int tid_ = threadIdx.x; asm volatile("" : "+v"(tid_));
    const int tid = tid_, wid = __builtin_amdgcn_readfirstlane(tid >> 6), lane = tid & 63, wr = wid >> 2, wc = wid & 3, fr = lane & 15, fq = lane >> 4;
    const int K = g.K, nt = K / BK;
    unsigned voffA[2], voffB[2];
#pragma unroll
    for (int i = 0; i < 2; ++i) { int R, C; stage_rc(tid * 16 + i * 8192, R, C); const int Rb = Epi::PERM ? ((R & ~31) + perm32(R & 31)) : R;
        voffA[i] = (unsigned)(R * K + C) * 2u; voffB[i] = (unsigned)(Rb * K + C) * 2u; }
    const size_t kstep = (size_t)(BK * 2);
    const size_t hstep = (size_t)HALF * K * 2;
    const size_t tstep = 2 * hstep;
    const unsigned ldsw = (unsigned)wid * 1024u;
    const int aoff = lds_byte(wr * 64 + fr, fq * 8), boff = lds_byte(wc * 32 + fr, fq * 8);
#define PG8_SA(b, h) (((b) * 2 + (h)) * HTB)
#define PG8_SB(b, h) ((4 + (b) * 2 + (h)) * HTB)
#define PG8_STAGE(bufoff, gbase, voff) do { _Pragma("unroll") for (int _i = 0; _i < 2; ++_i) \
        __builtin_amdgcn_global_load_lds((const unsigned*)((const char*)(gbase) + (voff)[_i]), (PG8_LAS unsigned*)(lds + (bufoff) + ldsw + _i * 8192), 16, 0, 0); } while (0)
#define PG8_LDA(dst, b, h) do { _Pragma("unroll") for (int m = 0; m < 4; ++m) _Pragma("unroll") for (int k = 0; k < 2; ++k) dst[m][k] = *(const PG8_LAS bf16x8*)(lds + PG8_SA(b, h) + aoff + m * 2048 + k * 1024); } while (0)
#define PG8_LDB(dst, b, h) do { _Pragma("unroll") for (int n = 0; n < 2; ++n) _Pragma("unroll") for (int k = 0; k < 2; ++k) dst[n][k] = *(const PG8_LAS bf16x8*)(lds + PG8_SB(b, h) + boff + n * 2048 + k * 1024); } while (0)
#define PG8_MMA(ai, bj, At, Bt) do { __builtin_amdgcn_s_setprio(1); _Pragma("unroll") for (int m = 0; m < 4; ++m) _Pragma("unroll") for (int n = 0; n < 2; ++n) _Pragma("unroll") for (int k = 0; k < 2; ++k) \
        acc[ai][bj][m][n] = __builtin_amdgcn_mfma_f32_16x16x32_bf16(Bt[n][k], At[m][k], acc[ai][bj][m][n], 0, 0, 0); __builtin_amdgcn_s_setprio(0); } while (0)
#define PG8_WAIT_V(n) asm volatile("s_waitcnt vmcnt(" #n ")" ::: "memory")
#define PG8_WAIT_L(n) asm volatile("s_waitcnt lgkmcnt(" #n ")" ::: "memory")
#define PG8_BAR __builtin_amdgcn_s_barrier()
#define PG8_SCHED __builtin_amdgcn_sched_barrier(0)
    Unit cur, nxt; int ui = 0;
    if (!S.next(0, cur)) return;
    f32x4 acc[2][2][4][2];
#pragma unroll
    for (int a = 0; a < 2; ++a)
#pragma unroll
        for (int b = 0; b < 2; ++b)
#pragma unroll
            for (int m = 0; m < 4; ++m)
#pragma unroll
                for (int n = 0; n < 2; ++n) acc[a][b][m][n] = (f32x4){0.f, 0.f, 0.f, 0.f};
    bf16x8 At[4][2], B0[2][2], B1[2][2];
    const char* cA = (const char*)g.A + (size_t)cur.pm * tstep; const char* cB = (const char*)g.Bt + (size_t)cur.pn * tstep;
    S.a_ready(cur);
    if constexpr (SP2) {
        PG8_STAGE(PG8_SB(0, 0), cB, voffB); PG8_STAGE(PG8_SB(0, 1), cB + hstep, voffB); PG8_STAGE(PG8_SA(0, 0), cA, voffA); PG8_STAGE(PG8_SA(0, 1), cA + hstep, voffA);
        if (wr == 1) PG8_BAR;
        PG8_WAIT_V(2); PG8_BAR;
        PG8_STAGE(PG8_SB(1, 0), cB + kstep, voffB); PG8_STAGE(PG8_SA(1, 0), cA + kstep, voffA); PG8_STAGE(PG8_SB(1, 1), cB + hstep + kstep, voffB);
        PG8_WAIT_V(6); PG8_BAR;
    } else {
        PG8_STAGE(PG8_SB(0, 0), cB, voffB); PG8_STAGE(PG8_SA(0, 0), cA, voffA); PG8_STAGE(PG8_SB(0, 1), cB + hstep, voffB); PG8_STAGE(PG8_SA(0, 1), cA + hstep, voffA);
        if (wr == 1) PG8_BAR;
        PG8_WAIT_V(4); PG8_BAR;
        PG8_STAGE(PG8_SB(1, 0), cB + kstep, voffB); PG8_STAGE(PG8_SA(1, 0), cA + kstep, voffA); PG8_STAGE(PG8_SB(1, 1), cB + hstep + kstep, voffB);
        PG8_WAIT_V(6); PG8_BAR;
    }
    for (;;) {
        const bool has_next = S.next(ui + 1, nxt);
        const char* nA = has_next ? (const char*)g.A + (size_t)nxt.pm * tstep : cA; const char* nB = has_next ? (const char*)g.Bt + (size_t)nxt.pn * tstep : cB;
        for (int t = 0; t < nt; t += 2) {
            const bool last = (t == nt - 2);
            const char* a1 = cA + (size_t)(t + 1) * kstep;
            const char* a2 = last ? nA : cA + (size_t)(t + 2) * kstep; const char* b2 = last ? nB : cB + (size_t)(t + 2) * kstep;
            const char* a3 = a2 + kstep; const char* b3 = b2 + kstep;
            if (last && has_next) S.a_ready(nxt);
            if constexpr (SP2) {
            PG8_LDB(B0, 0, 0); PG8_LDB(B1, 0, 1); PG8_SCHED; PG8_LDA(At, 0, 0); PG8_STAGE(PG8_SA(1, 1), a1 + hstep, voffA);
            PG8_WAIT_V(8); PG8_WAIT_L(0); PG8_BAR; PG8_MMA(0, 0, At, B0); PG8_MMA(0, 1, At, B1); PG8_BAR; PG8_SCHED;
            PG8_LDA(At, 0, 1); PG8_STAGE(PG8_SB(0, 0), b2, voffB); PG8_STAGE(PG8_SB(0, 1), b2 + hstep, voffB); PG8_STAGE(PG8_SA(0, 0), a2, voffA);
            PG8_WAIT_V(8); PG8_WAIT_L(0); PG8_BAR; PG8_MMA(1, 0, At, B0); PG8_MMA(1, 1, At, B1); PG8_BAR; PG8_SCHED;
            PG8_LDB(B0, 1, 0); PG8_LDB(B1, 1, 1); PG8_SCHED; PG8_LDA(At, 1, 0); PG8_STAGE(PG8_SA(0, 1), a2 + hstep, voffA);
            PG8_WAIT_V(8); PG8_WAIT_L(0); PG8_BAR; PG8_MMA(0, 0, At, B0); PG8_MMA(0, 1, At, B1); PG8_BAR; PG8_SCHED;
            PG8_LDA(At, 1, 1); PG8_STAGE(PG8_SB(1, 0), b3, voffB); PG8_STAGE(PG8_SB(1, 1), b3 + hstep, voffB); PG8_STAGE(PG8_SA(1, 0), a3, voffA);
            PG8_WAIT_V(8); PG8_WAIT_L(0); PG8_BAR; PG8_MMA(1, 0, At, B0); PG8_MMA(1, 1, At, B1); PG8_BAR; PG8_SCHED;
            } else {
            PG8_LDB(B0, 0, 0); PG8_SCHED; PG8_LDA(At, 0, 0); PG8_STAGE(PG8_SA(1, 1), a1 + hstep, voffA);
            PG8_WAIT_L(8); PG8_BAR; PG8_WAIT_L(0); PG8_MMA(0, 0, At, B0); PG8_BAR; PG8_SCHED;
            PG8_LDB(B1, 0, 1); PG8_STAGE(PG8_SB(0, 0), b2, voffB);
            PG8_BAR; PG8_WAIT_L(0); PG8_MMA(0, 1, At, B1); PG8_BAR;
            PG8_LDA(At, 0, 1); PG8_STAGE(PG8_SA(0, 0), a2, voffA);
            PG8_BAR; PG8_WAIT_L(0); PG8_MMA(1, 0, At, B0); PG8_BAR; PG8_SCHED;
            PG8_STAGE(PG8_SB(0, 1), b2 + hstep, voffB);
            PG8_WAIT_V(6); PG8_BAR; PG8_MMA(1, 1, At, B1); PG8_BAR;
            PG8_LDB(B0, 1, 0); PG8_SCHED; PG8_LDA(At, 1, 0); PG8_STAGE(PG8_SA(0, 1), a2 + hstep, voffA);
            PG8_WAIT_L(8); PG8_BAR; PG8_WAIT_L(0); PG8_MMA(0, 0, At, B0); PG8_BAR; PG8_SCHED;
            PG8_LDB(B1, 1, 1); PG8_STAGE(PG8_SB(1, 0), b3, voffB);
            PG8_BAR; PG8_WAIT_L(0); PG8_MMA(0, 1, At, B1); PG8_BAR;
            PG8_LDA(At, 1, 1); PG8_STAGE(PG8_SA(1, 0), a3, voffA);
            PG8_BAR; PG8_WAIT_L(0); PG8_MMA(1, 0, At, B0); PG8_BAR; PG8_SCHED;
            PG8_STAGE(PG8_SB(1, 1), b3 + hstep, voffB);
            PG8_WAIT_V(6); PG8_BAR; PG8_MMA(1, 1, At, B1); PG8_BAR;
            }
        }
        if constexpr (ALIGN_EPI) { if (wr == 0) PG8_BAR; }
        if constexpr (!Epi::AFTER_DRAIN) { E(acc, cur, wr, wc, fr, fq); S.done(cur); }
        if (!has_next) break;
#pragma unroll
        for (int a = 0; a < 2; ++a)
#pragma unroll
            for (int b = 0; b < 2; ++b)
#pragma unroll
                for (int m = 0; m < 4; ++m)
#pragma unroll
                    for (int n = 0; n < 2; ++n) acc[a][b][m][n] = (f32x4){0.f, 0.f, 0.f, 0.f};
        cur = nxt; cA = nA; cB = nB; ++ui;
        if constexpr (ALIGN_EPI) { if (wr == 1) PG8_BAR; }
    }
    PG8_WAIT_V(0);
    if constexpr (!ALIGN_EPI) { if (wr == 0) PG8_BAR; }
    PG8_BAR;
    if constexpr (Epi::AFTER_DRAIN) { E.fused(acc, cur, wr, wc, fr, fq, lds, wid, lane); S.done(cur); }
#undef PG8_SA
#undef PG8_SB
#undef PG8_STAGE
#undef PG8_LDA
#undef PG8_LDB
#undef PG8_MMA
#undef PG8_WAIT_V
#undef PG8_WAIT_L
#undef PG8_BAR
#undef PG8_SCHED
}
}

constexpr int NWAVES = 8;
constexpr int SEQ = 8192, DM = 2048, DFF = 5632, NPROJ = 5632, NINP = 5640, NLAYER = 4, HDIM = 128;
constexpr float NORM_EPS = 1e-6f;
constexpr float QK_SCALE = 0.08838834764831845f;
constexpr float SB_CUT = -104.0f;
constexpr int PC_CB = 0, PC_CC = 512, PC_CU = 1024, PC_MQ = 1536, PC_MK = 2048, PC_MV = 2560, PC_MO = 3072, PC_PU = 3584, PC_SQ = 4096, PC_SK = 4608, PC_SV = 5120;

constexpr size_t MiB = 1u << 20;
constexpr size_t WS_CTL = 0, CTL_ZERO_BYTES = 1 * MiB;
constexpr size_t WS_WG = 1 * MiB;
constexpr size_t WS_GATES = 1 * MiB + 256 * 1024;
constexpr size_t WS_SCAL = 1 * MiB + 512 * 1024;
constexpr size_t WS_MST = WS_SCAL + 4096;
constexpr size_t WS_NLOC = WS_SCAL + 65536;
constexpr size_t WS_NST = WS_NLOC + 131072;
constexpr size_t WS_W = 2 * MiB;
constexpr size_t WL_STRIDE = 162 * MiB, WL_GU1 = 0, WL_D1 = 44 * MiB, WL_IN = 66 * MiB, WL_OUT = 88 * MiB, WL_GU2 = 96 * MiB, WL_D2 = 140 * MiB;
constexpr size_t WS_H = 650 * MiB;
constexpr size_t WS_ACT = 682 * MiB;
constexpr size_t WS_Y = 770 * MiB;
constexpr size_t WS_YCAT = 834 * MiB;
constexpr size_t WS_UT = 866 * MiB;
constexpr size_t WS_CT = 882 * MiB;
constexpr size_t WS_END = 898 * MiB;
static_assert(WS_NST + 131072 <= WS_W && WS_W + 4 * WL_STRIDE == WS_H, "ws map");
constexpr int CW_BAR = 4096;

constexpr int RING_BYTES = 131072;
constexpr int LDSCTL_OFF = RING_BYTES, MISC_OFF = LDSCTL_OFF + 320;
constexpr int LDS_BYTES = 147456;

#define GAS __attribute__((address_space(1)))
#define LAS __attribute__((address_space(3)))
typedef unsigned short bf16;
typedef unsigned v4u __attribute__((ext_vector_type(4)));
typedef unsigned v2u __attribute__((ext_vector_type(2)));
typedef float f32x4 __attribute__((ext_vector_type(4)));
typedef short bf16x8 __attribute__((ext_vector_type(8)));
#define LDS_WAIT() asm volatile("s_waitcnt lgkmcnt(0)" ::: "memory")
#define VM_WAIT() asm volatile("s_waitcnt vmcnt(0)" ::: "memory")
#define MFMA16(a, b, c) __builtin_amdgcn_mfma_f32_16x16x32_bf16((a), (b), (c), 0, 0, 0)
__device__ __forceinline__ unsigned f2bf(float f) { unsigned u = __builtin_bit_cast(unsigned, f); return (u + 0x7fffu + ((u >> 16) & 1u)) >> 16; }
__device__ __forceinline__ unsigned pk2(float lo, float hi) { return f2bf(lo) | (f2bf(hi) << 16); }
__device__ __forceinline__ float bflo(unsigned w) { return __builtin_bit_cast(float, w << 16); }
__device__ __forceinline__ float bfhi(unsigned w) { return __builtin_bit_cast(float, w & 0xffff0000u); }
__device__ __forceinline__ float bf2f(bf16 b) { return __builtin_bit_cast(float, (unsigned)b << 16); }
__device__ __forceinline__ void unpack8(const v4u v, float (&f)[8]) { f[0] = bflo(v.x); f[1] = bfhi(v.x); f[2] = bflo(v.y); f[3] = bfhi(v.y); f[4] = bflo(v.z); f[5] = bfhi(v.z); f[6] = bflo(v.w); f[7] = bfhi(v.w); }
__device__ __forceinline__ v4u pack8(const float (&f)[8]) { v4u o; o.x = pk2(f[0], f[1]); o.y = pk2(f[2], f[3]); o.z = pk2(f[4], f[5]); o.w = pk2(f[6], f[7]); return o; }
__device__ __forceinline__ float softplus_f(float z) { return fmaxf(z, 0.f) + __logf(1.f + __expf(-fabsf(z))); }
__device__ __forceinline__ float wave_sum(float v) {
#pragma unroll
    for (int o = 1; o < 64; o <<= 1) v += __shfl_xor(v, o);
    return v;
}
__device__ __forceinline__ float wave_max(float v) {
#pragma unroll
    for (int o = 1; o < 64; o <<= 1) v = fmaxf(v, __shfl_xor(v, o));
    return v;
}
__device__ __forceinline__ float red16_sum(float v) { v += __shfl_xor(v, 1); v += __shfl_xor(v, 2); v += __shfl_xor(v, 4); v += __shfl_xor(v, 8); return v; }

#define XB_TMO      128
#define XB_XCNT(j)  (256  + 64 * (j))
#define XB_XSUB(j)  (1280 + 64 * (j))
#define XB_XGEN(j)  (2304 + 64 * (j))
#define XB_TOP      3328
#define XB_TOPGEN   3392
#define XCD_BAR_WORDS 3456
#define XB_SPIN_CAP (1u << 18)

__device__ __forceinline__ unsigned xb_ld(unsigned* p)              { return __hip_atomic_load(p, __ATOMIC_RELAXED, __HIP_MEMORY_SCOPE_AGENT); }
__device__ __forceinline__ unsigned xb_add(unsigned* p, unsigned v) { return __hip_atomic_fetch_add(p, v, __ATOMIC_RELAXED, __HIP_MEMORY_SCOPE_AGENT); }
__device__ __forceinline__ unsigned xb_xcc_id() { return (unsigned)__builtin_amdgcn_s_getreg((3 << 11) | 20) & 0xFu; }
#define XB_SPIN(cond, bar) do { unsigned _sp = 0; while (cond) { __builtin_amdgcn_s_sleep(1); \
    if ((++_sp & 255u) == 0u) { if (xb_ld(&(bar)[XB_TMO])) break; if (_sp > XB_SPIN_CAP) { atomicAdd(&(bar)[XB_TMO], 1u); break; } } } } while (0)

struct XcdBarrier {
    unsigned* bar; unsigned x;
    volatile LAS unsigned* st;
};

__device__ __forceinline__ XcdBarrier xcd_barrier_post(unsigned* bar, volatile LAS unsigned* st) {
    XcdBarrier b; b.bar = bar; b.x = xb_xcc_id(); b.st = st;
    if (threadIdx.x == 0) (void)xb_add(&bar[XB_XCNT(b.x)], 1u);
    return b;
}
__device__ __forceinline__ void xcd_barrier_complete(unsigned* bar, unsigned x, unsigned& nloc, unsigned& nx) {
    const unsigned G = gridDim.x * gridDim.y * gridDim.z;
    unsigned sum, cnt, mine, sp = 0u;
    for (;;) {
        sum = 0u; cnt = 0u; mine = 0u;
#pragma unroll
        for (unsigned j = 0; j < 16; ++j) { const unsigned c = xb_ld(&bar[XB_XCNT(j)]); sum += c; cnt += (c > 0u) ? 1u : 0u; mine = (j == x) ? c : mine; }
        if (sum == G) break;
        __builtin_amdgcn_s_sleep(1);
        if ((++sp & 255u) == 0u) { if (xb_ld(&bar[XB_TMO])) break; if (sp > XB_SPIN_CAP) { atomicAdd(&bar[XB_TMO], 1u); break; } }
    }
    nloc = mine > 0u ? mine : 1u; nx = cnt > 0u ? cnt : 1u;
}

__device__ __forceinline__ void xcd_barrier(const XcdBarrier& b) {
    asm volatile("s_waitcnt vmcnt(0)" ::: "memory");
    __syncthreads();
    if (threadIdx.x == 0) {
        unsigned* bar = b.bar;
        __builtin_amdgcn_s_waitcnt(0);
        unsigned nloc = b.st[0], nx = b.st[1];
        if (nloc == 0u) { xcd_barrier_complete(bar, b.x, nloc, nx); b.st[0] = nloc; b.st[1] = nx; }
        const unsigned old = xb_add(&bar[XB_XSUB(b.x)], 1u);
        const unsigned gen = old / nloc;
        if (old + 1u == (gen + 1u) * nloc) {
            __builtin_amdgcn_fence(__ATOMIC_RELEASE, "agent");
            asm volatile("s_waitcnt vmcnt(0)" ::: "memory");
            const unsigned og = xb_add(&bar[XB_TOP], 1u);
            const unsigned tg = og / nx;
            if (og + 1u == (tg + 1u) * nx) xb_add(&bar[XB_TOPGEN], 1u);
            else XB_SPIN(xb_ld(&bar[XB_TOPGEN]) == tg, bar);
            __builtin_amdgcn_fence(__ATOMIC_ACQUIRE, "agent");
            xb_add(&bar[XB_XGEN(b.x)], 1u);
            asm volatile("s_waitcnt vmcnt(0)" ::: "memory");
        } else {
            XB_SPIN(xb_ld(&bar[XB_XGEN(b.x)]) == gen, bar);
            __builtin_amdgcn_fence(__ATOMIC_ACQUIRE, "agent");
            asm volatile("s_waitcnt vmcnt(0)" ::: "memory");
        }
    }
    __syncthreads();
}

__device__ __forceinline__ void transpose_item(const float* W, int Nsrc, int csrc, bf16* WT, int K, int drow0, int k0, LAS float* scr, int lane) {
#pragma unroll 8
    for (int i = 0; i < 32; ++i) { const int kk = 2 * i + (lane >> 5); scr[kk * 33 + (lane & 31)] = W[(size_t)(k0 + kk) * Nsrc + csrc + (lane & 31)]; }
    LDS_WAIT();
    const int c = lane & 7;
#pragma unroll
    for (int j = 0; j < 4; ++j) { const int n = (lane >> 3) + 8 * j; const LAS float* s = scr + (8 * c) * 33 + n;
        v4u o; o.x = pk2(s[0 * 33], s[1 * 33]); o.y = pk2(s[2 * 33], s[3 * 33]); o.z = pk2(s[4 * 33], s[5 * 33]); o.w = pk2(s[6 * 33], s[7 * 33]);
        *(v4u*)(WT + (size_t)(drow0 + n) * K + k0 + 8 * c) = o; }
    LDS_WAIT();
}
constexpr int IT_GU = (DM / 64) * (2 * DFF / 32);
constexpr int IT_D = (DFF / 64) * (DM / 32);
constexpr int IT_IN = (DM / 64) * (NPROJ / 32);
constexpr int IT_OUT = (DM / 64) * (DM / 32);
constexpr int IT_LAYER = 2 * IT_GU + 2 * IT_D + IT_IN + IT_OUT;
constexpr int IT_CONV = NLAYER * IT_LAYER;
constexpr int IT_FOLD = NLAYER * 512;
constexpr int IT_WG = NLAYER * 8;
constexpr int IT_ALL = IT_CONV + IT_FOLD + IT_WG;

struct Ptrs {
    const float *x, *w_in, *w_out, *conv_w, *pool_w, *pool_scale, *i_bias, *f_bias, *head_gain, *g1, *u1, *d1, *g2, *u2, *d2, *gains;
    float* out; unsigned char* ws;
};

__device__ __forceinline__ void gu_item(const float* Wg, const float* Wu, bf16* WT, int r, LAS float* scr, int lane) {
    const int kb = r / 352, nb = r % 352, n0 = 32 * nb, pn = n0 >> 8, within = n0 & 255;
    transpose_item(within < 128 ? Wg : Wu, DFF, 128 * pn + (within & 127), WT, DM, n0, 64 * kb, scr, lane);
}
__device__ __forceinline__ void prologue(const Ptrs& p, LAS unsigned char* lds, int gw, int NGW, int wave, int lane) {
    asm volatile("" : "+v"(lane));
    LAS float* scr = (LAS float*)(lds + wave * 16384);
    for (int it = gw; it < IT_ALL; it += NGW) {
        if (it < IT_CONV) {
            const int l = it / IT_LAYER; int r = it % IT_LAYER;
            unsigned char* wl = p.ws + WS_W + (size_t)l * WL_STRIDE;
            const size_t off_ff = (size_t)l * DM * DFF;
            if (r < IT_GU) { gu_item(p.g1 + off_ff, p.u1 + off_ff, (bf16*)(wl + WL_GU1), r, scr, lane); continue; } r -= IT_GU;
            if (r < IT_GU) { gu_item(p.g2 + off_ff, p.u2 + off_ff, (bf16*)(wl + WL_GU2), r, scr, lane); continue; } r -= IT_GU;
            if (r < IT_D) { const int kb = r / 64, nb = r % 64; transpose_item(p.d1 + off_ff, DM, 32 * nb, (bf16*)(wl + WL_D1), DFF, 32 * nb, 64 * kb, scr, lane); continue; } r -= IT_D;
            if (r < IT_D) { const int kb = r / 64, nb = r % 64; transpose_item(p.d2 + off_ff, DM, 32 * nb, (bf16*)(wl + WL_D2), DFF, 32 * nb, 64 * kb, scr, lane); continue; } r -= IT_D;
            if (r < IT_IN) { const int kb = r / 176, nb = r % 176, n0 = 32 * nb; transpose_item(p.w_in + (size_t)l * DM * NINP, NINP, n0 + (n0 >= 3584 ? 8 : 0), (bf16*)(wl + WL_IN), DM, n0, 64 * kb, scr, lane); continue; } r -= IT_IN;
            { const int kb = r / 64, nb = r % 64; if (kb >= 16 && kb < 24) continue;
              transpose_item(p.w_out + (size_t)l * DM * DM, DM, 32 * nb, (bf16*)(wl + WL_OUT), DM, 32 * nb, 64 * kb, scr, lane); }
        } else if (it < IT_CONV + IT_FOLD) {
            const int f = it - IT_CONV, l = f >> 9, r = f & 511, g = r >> 7, nblk = (r & 127) >> 2, cq = r & 3, n = 64 * nblk + lane;
            const float* wo = p.w_out + (size_t)l * DM * DM + (size_t)(1024 + 128 * g) * DM + n;
            const float* pw = p.pool_w + ((size_t)l * 4 + g) * 128 * 128;
            const float* sc = p.pool_scale + l * 512 + 128 * g;
            bf16* dst = (bf16*)(p.ws + WS_W + (size_t)l * WL_STRIDE + WL_OUT) + (size_t)n * DM + 1024 + 128 * g + 32 * cq;
            for (int c8 = 0; c8 < 4; ++c8) {
                float acc[8];
#pragma unroll
                for (int i = 0; i < 8; ++i) acc[i] = 0.f;
                const float* pwc = pw + (size_t)(32 * cq + 8 * c8) * 128;
                for (int d = 0; d < 128; ++d) { const float wv = sc[d] * wo[(size_t)d * DM];
#pragma unroll
                    for (int i = 0; i < 8; ++i) acc[i] += pwc[i * 128 + d] * wv; }
                *(v4u*)(dst + 8 * c8) = pack8(acc);
            }
        } else {
            const int f = it - IT_CONV - IT_FOLD, l = f >> 3, c = f & 7;
            float* wg = (float*)(p.ws + WS_WG) + (size_t)(l * 8 + c) * DM;
            const float* src = p.w_in + (size_t)l * DM * NINP + 3584 + c;
            for (int k = lane; k < DM; k += 64) wg[k] = src[(size_t)k * NINP];
        }
    }
    const float* g0 = p.gains;
    for (int row = gw; row < SEQ; row += NGW) {
        const f32x4* xr = (const f32x4*)(p.x + (size_t)row * DM) + lane; f32x4* orow = (f32x4*)(p.out + (size_t)row * DM) + lane;
        f32x4 v[8]; float ss = 0.f;
#pragma unroll
        for (int j = 0; j < 8; ++j) { v[j] = xr[64 * j]; ss += (v[j].x * v[j].x + v[j].y * v[j].y) + (v[j].z * v[j].z + v[j].w * v[j].w); }
        const float rs = rsqrtf(wave_sum(ss) * (1.f / DM) + NORM_EPS);
        v2u* hr = (v2u*)((bf16*)(p.ws + WS_H) + (size_t)row * DM) + lane;
#pragma unroll
        for (int j = 0; j < 8; ++j) { orow[64 * j] = v[j]; const f32x4 g = ((const f32x4*)g0)[64 * j + lane]; const f32x4 h = v[j] * rs * g;
            v2u o; o.x = pk2(h.x, h.y); o.y = pk2(h.z, h.w); hr[64 * j] = o; }
    }
}

__device__ __forceinline__ void thin_phase(const float* Y, float* X, bf16* H, float coef, const float* gpost, const float* gpre, const float* WG, const float* ibias, const float* fbias, float* gates,
                                           int gw, int NGW, int lane) {
    asm volatile("" : "+v"(lane));
    for (int row = gw; row < SEQ; row += NGW) {
        const f32x4* yr = (const f32x4*)(Y + (size_t)row * DM) + lane; f32x4* xr = (f32x4*)(X + (size_t)row * DM) + lane;
        f32x4 v[8]; float ss = 0.f;
#pragma unroll
        for (int j = 0; j < 8; ++j) { v[j] = yr[64 * j]; ss += (v[j].x * v[j].x + v[j].y * v[j].y) + (v[j].z * v[j].z + v[j].w * v[j].w); }
        const float rs = coef * rsqrtf(wave_sum(ss) * (1.f / DM) + NORM_EPS);
        float ss2 = 0.f;
#pragma unroll
        for (int j = 0; j < 8; ++j) { const f32x4 g = ((const f32x4*)gpost)[64 * j + lane]; f32x4 x = xr[64 * j]; x = x + v[j] * rs * g; xr[64 * j] = x; v[j] = x;
            ss2 += (x.x * x.x + x.y * x.y) + (x.z * x.z + x.w * x.w); }
        if (gpre) {
            const float rs2 = rsqrtf(wave_sum(ss2) * (1.f / DM) + NORM_EPS);
            v2u* hr = (v2u*)(H + (size_t)row * DM) + lane;
#pragma unroll
            for (int j = 0; j < 8; ++j) { const f32x4 g = ((const f32x4*)gpre)[64 * j + lane]; const f32x4 h = v[j] * rs2 * g; v[j] = h;
                v2u o; o.x = pk2(h.x, h.y); o.y = pk2(h.z, h.w); hr[64 * j] = o; }
            if (WG) {
                float myv = 0.f;
#pragma unroll
                for (int c = 0; c < 8; ++c) { float d = 0.f; const f32x4* wr = (const f32x4*)(WG + (size_t)c * DM) + lane;
#pragma unroll
                    for (int j = 0; j < 8; ++j) { const f32x4 w = wr[64 * j]; d += (v[j].x * w.x + v[j].y * w.y) + (v[j].z * w.z + v[j].w * w.w); }
                    d = wave_sum(d); if (lane == c) myv = d + (c < 4 ? ibias[c] : fbias[c - 4]); }
                if (lane < 8) gates[(size_t)row * 8 + lane] = myv;
            }
        }
    }
}

__device__ __forceinline__ void mix_elem(const bf16* P, bf16* YC, const float* convw, int gtid, int gstride) {
    asm volatile("" : "+v"(gtid));
    for (int idx = gtid; idx < SEQ * 128; idx += gstride) {
        const int t = idx >> 7, cg = idx & 127;
        if (cg < 64) {
            const int ch = cg * 8; float acc[8];
#pragma unroll
            for (int i = 0; i < 8; ++i) acc[i] = 0.f;
#pragma unroll
            for (int j = 0; j < 3; ++j) { const int tt = t - 2 + j; if (tt < 0) continue;
                float c[8], u[8]; unpack8(*(const v4u*)(P + (size_t)tt * NPROJ + PC_CC + ch), c); unpack8(*(const v4u*)(P + (size_t)tt * NPROJ + PC_CU + ch), u);
                const float* w = convw + j * 512 + ch;
#pragma unroll
                for (int i = 0; i < 8; ++i) acc[i] += w[i] * (c[i] * u[i]); }
            float b[8]; unpack8(*(const v4u*)(P + (size_t)t * NPROJ + PC_CB + ch), b);
#pragma unroll
            for (int i = 0; i < 8; ++i) acc[i] *= b[i];
            *(v4u*)(YC + (size_t)t * DM + ch) = pack8(acc);
        } else {
            const int ch = (cg - 64) * 8, g = ch >> 7, w = 2 << g; const int lo = (t + 1 - w) > 0 ? (t + 1 - w) : 0; const float inv = 1.0f / (float)(t + 1 - lo);
            float s[8];
#pragma unroll
            for (int i = 0; i < 8; ++i) s[i] = 0.f;
            for (int tt = lo; tt <= t; ++tt) { float u[8]; unpack8(*(const v4u*)(P + (size_t)tt * NPROJ + PC_PU + ch), u);
#pragma unroll
                for (int i = 0; i < 8; ++i) s[i] += u[i]; }
            float u[8]; unpack8(*(const v4u*)(P + (size_t)t * NPROJ + PC_PU + ch), u);
#pragma unroll
            for (int i = 0; i < 8; ++i) s[i] = s[i] * inv - u[i];
            *(v4u*)(YC + (size_t)t * DM + 1024 + ch) = pack8(s);
        }
    }
}

__device__ __forceinline__ void attn_phase(LAS unsigned char* lds, const bf16* P, bf16* YC, int G, int bid, int tid) {
    asm volatile("" : "+v"(tid));
    const int lane = tid & 63, w = __builtin_amdgcn_readfirstlane(tid >> 6), fr = lane & 15, fq = lane >> 4;
    LAS bf16* Ks = (LAS bf16*)lds;
    LAS bf16* Vt = (LAS bf16*)(lds + 17408);
    LAS float* Sb = (LAS float*)(lds + 35840);
    LAS bf16* Pb = (LAS bf16*)(lds + 70656);
    LAS float* wmax = (LAS float*)(lds + 89088);
    for (int u = bid; u < 256; u += G) {
        const int qb = u >> 2, h = u & 3, t0 = qb * 128, trow = t0 + 16 * w + fr;
        bf16x8 qf[4];
        { const bf16* qrow = P + (size_t)trow * NPROJ + PC_SQ + h * HDIM + 8 * fq;
#pragma unroll
          for (int ks = 0; ks < 4; ++ks) qf[ks] = *(const bf16x8*)(qrow + 32 * ks); }
        f32x4 o[8];
#pragma unroll
        for (int nt = 0; nt < 8; ++nt) o[nt] = (f32x4){0.f, 0.f, 0.f, 0.f};
        float carry = 0.f;
        for (int kt = 2 * qb + 1; kt >= 0; --kt) {
            __syncthreads();
            if (kt != 2 * qb + 1) { float m = wmax[0];
#pragma unroll
                for (int i = 1; i < 8; ++i) m = fmaxf(m, wmax[i]);
                if (m < SB_CUT) break; }
#pragma unroll
            for (int i = 0; i < 2; ++i) { const int pp = tid + 512 * i, row = pp >> 4, c16 = pp & 15;
                *(LAS v4u*)(Ks + row * 136 + c16 * 8) = *(const v4u*)(P + (size_t)(64 * kt + row) * NPROJ + PC_SK + h * HDIM + c16 * 8); }
#pragma unroll
            for (int i = 0; i < 2; ++i) { const int pp = tid + 512 * i, s = pp & 63, c16 = pp >> 6;
                const v4u v = *(const v4u*)(P + (size_t)(64 * kt + s) * NPROJ + PC_SV + h * HDIM + c16 * 8);
                LAS bf16* d = Vt + (c16 * 8) * 72 + s;
                d[0 * 72] = (bf16)(v.x & 0xffffu); d[1 * 72] = (bf16)(v.x >> 16); d[2 * 72] = (bf16)(v.y & 0xffffu); d[3 * 72] = (bf16)(v.y >> 16);
                d[4 * 72] = (bf16)(v.z & 0xffffu); d[5 * 72] = (bf16)(v.z >> 16); d[6 * 72] = (bf16)(v.w & 0xffffu); d[7 * 72] = (bf16)(v.w >> 16); }
            __syncthreads();
            { f32x4 sa[4];
#pragma unroll
              for (int nt = 0; nt < 4; ++nt) sa[nt] = (f32x4){0.f, 0.f, 0.f, 0.f};
#pragma unroll
              for (int ks = 0; ks < 4; ++ks)
#pragma unroll
                  for (int nt = 0; nt < 4; ++nt) { const bf16x8 kf = *(const LAS bf16x8*)(Ks + (16 * nt + fr) * 136 + 32 * ks + 8 * fq); sa[nt] = MFMA16(qf[ks], kf, sa[nt]); }
#pragma unroll
              for (int nt = 0; nt < 4; ++nt)
#pragma unroll
                  for (int r = 0; r < 4; ++r) Sb[(16 * w + 4 * fq + r) * 68 + 16 * nt + fr] = sa[nt][r] * QK_SCALE; }
            LDS_WAIT();
            float z[16], lsn[16];
#pragma unroll
            for (int i = 0; i < 4; ++i) { const f32x4 t4 = *(const LAS f32x4*)(Sb + (16 * w + fr) * 68 + 16 * fq + 4 * i); z[4 * i] = t4.x; z[4 * i + 1] = t4.y; z[4 * i + 2] = t4.z; z[4 * i + 3] = t4.w; }
            const int sg0 = 64 * kt + 16 * fq; float tot = 0.f;
#pragma unroll
            for (int i = 0; i < 16; ++i) { lsn[i] = (sg0 + i < trow) ? -softplus_f(z[i]) : 0.f; tot += lsn[i]; }
            const float t0_ = __shfl(tot, fr), t1_ = __shfl(tot, fr + 16), t2_ = __shfl(tot, fr + 32), t3_ = __shfl(tot, fr + 48);
            float run = carry + (fq < 1 ? t1_ : 0.f) + (fq < 2 ? t2_ : 0.f) + (fq < 3 ? t3_ : 0.f);
            float pv[16];
#pragma unroll
            for (int i = 15; i >= 0; --i) { pv[i] = (sg0 + i < trow) ? __expf(z[i] + lsn[i] + run) : 0.f; run += lsn[i]; }
            carry += (t0_ + t1_) + (t2_ + t3_);
            { v4u a, b; a.x = pk2(pv[0], pv[1]); a.y = pk2(pv[2], pv[3]); a.z = pk2(pv[4], pv[5]); a.w = pk2(pv[6], pv[7]);
              b.x = pk2(pv[8], pv[9]); b.y = pk2(pv[10], pv[11]); b.z = pk2(pv[12], pv[13]); b.w = pk2(pv[14], pv[15]);
              *(LAS v4u*)(Pb + (16 * w + fr) * 72 + 16 * fq) = a; *(LAS v4u*)(Pb + (16 * w + fr) * 72 + 16 * fq + 8) = b; }
            { const float cm = wave_max(carry); if (lane == 0) wmax[w] = cm; }
            LDS_WAIT();
#pragma unroll
            for (int ks = 0; ks < 2; ++ks) { const bf16x8 pf = *(const LAS bf16x8*)(Pb + (16 * w + fr) * 72 + 32 * ks + 8 * fq);
#pragma unroll
                for (int nt = 0; nt < 8; ++nt) { const bf16x8 vf = *(const LAS bf16x8*)(Vt + (16 * nt + fr) * 72 + 32 * ks + 8 * fq); o[nt] = MFMA16(pf, vf, o[nt]); } }
        }
#pragma unroll
        for (int nt = 0; nt < 8; ++nt)
#pragma unroll
            for (int r = 0; r < 4; ++r) YC[(size_t)(t0 + 16 * w + 4 * fq + r) * DM + 1536 + h * HDIM + 16 * nt + fr] = (bf16)f2bf(o[nt][r]);
    }
}

__device__ __forceinline__ void mlstm_local(LAS unsigned char* lds, const bf16* P, const float* gates, float* UT, float* NLOC, float* SCAL, int G, int bid, int tid) {
    asm volatile("" : "+v"(tid));
    const int lane = tid & 63, w = __builtin_amdgcn_readfirstlane(tid >> 6), fr = lane & 15, fq = lane >> 4;
    LAS bf16* Vt = (LAS bf16*)lds;
    LAS bf16* Kw = (LAS bf16*)(lds + 34816);
    LAS float* lf_s = (LAS float*)(lds + 69632); LAS float* ig_s = lf_s + 128; LAS float* b_s = lf_s + 256; LAS float* wk_s = lf_s + 384;
    for (int u = bid; u < 256; u += G) {
        const int c = u >> 2, h = u & 3, tb = 128 * c;
        __syncthreads();
        if (tid < 128) { const float fp = gates[(size_t)(tb + tid) * 8 + 4 + h]; lf_s[tid] = -softplus_f(-fp); ig_s[tid] = gates[(size_t)(tb + tid) * 8 + h]; }
        __syncthreads();
        if (tid < 128) { float b = 0.f; for (int j = 0; j <= tid; ++j) b += lf_s[j]; b_s[tid] = b; }
        __syncthreads();
        const float blast = b_s[127]; float gmax = -3.0e38f;
        for (int s = 0; s < 128; ++s) gmax = fmaxf(gmax, blast - b_s[s] + ig_s[s]);
        if (tid < 128) wk_s[tid] = __expf(blast - b_s[tid] + ig_s[tid] - gmax);
        __syncthreads();
#pragma unroll
        for (int i = 0; i < 4; ++i) { const int pp = tid + 512 * i, s = pp & 127, c16 = pp >> 7;
            const v4u kv = *(const v4u*)(P + (size_t)(tb + s) * NPROJ + PC_MK + h * HDIM + c16 * 8), vv = *(const v4u*)(P + (size_t)(tb + s) * NPROJ + PC_MV + h * HDIM + c16 * 8);
            const float wsc = wk_s[s] * QK_SCALE; float kf[8]; unpack8(kv, kf);
            LAS bf16* dk = Kw + (c16 * 8) * 136 + s; LAS bf16* dv = Vt + (c16 * 8) * 136 + s;
#pragma unroll
            for (int e = 0; e < 8; ++e) dk[e * 136] = (bf16)f2bf(kf[e] * wsc);
            dv[0 * 136] = (bf16)(vv.x & 0xffffu); dv[1 * 136] = (bf16)(vv.x >> 16); dv[2 * 136] = (bf16)(vv.y & 0xffffu); dv[3 * 136] = (bf16)(vv.y >> 16);
            dv[4 * 136] = (bf16)(vv.z & 0xffffu); dv[5 * 136] = (bf16)(vv.z >> 16); dv[6 * 136] = (bf16)(vv.w & 0xffffu); dv[7 * 136] = (bf16)(vv.w >> 16); }
        __syncthreads();
        f32x4 acc[8];
#pragma unroll
        for (int nt = 0; nt < 8; ++nt) acc[nt] = (f32x4){0.f, 0.f, 0.f, 0.f};
#pragma unroll
        for (int ks = 0; ks < 4; ++ks) { const bf16x8 af = *(const LAS bf16x8*)(Vt + (16 * w + fr) * 136 + 32 * ks + 8 * fq);
#pragma unroll
            for (int nt = 0; nt < 8; ++nt) { const bf16x8 bfr = *(const LAS bf16x8*)(Kw + (16 * nt + fr) * 136 + 32 * ks + 8 * fq); acc[nt] = MFMA16(af, bfr, acc[nt]); } }
        float* ut = UT + (size_t)u * 16384;
#pragma unroll
        for (int nt = 0; nt < 8; ++nt)
#pragma unroll
            for (int r = 0; r < 4; ++r) ut[(16 * w + 4 * fq + r) * 128 + 16 * nt + fr] = acc[nt][r];
        if (tid < 128) { float sum = 0.f;
            for (int j = 0; j < 16; ++j) { float f[8]; unpack8(*(const LAS v4u*)(Kw + tid * 136 + 8 * j), f);
#pragma unroll
                for (int e = 0; e < 8; ++e) sum += f[e]; }
            NLOC[(size_t)u * 128 + tid] = sum; }
        if (tid == 0) { SCAL[2 * u] = blast; SCAL[2 * u + 1] = gmax; }
    }
}

__device__ __forceinline__ void mlstm_scan(LAS unsigned char* lds, const float* UT, float* CT, const float* NLOC, float* NST, const float* SCAL, float* MST, int G, int bid, int tid) {
    asm volatile("" : "+v"(tid));
    LAS float* dec = (LAS float*)lds; LAS float* scl = dec + 64; LAS float* tmp = dec + 128;
    for (int blk = bid; blk < 256; blk += G) {
        const int h = blk >> 6, sub = blk & 63;
        __syncthreads();
        if (tid < 128) tmp[tid] = SCAL[2 * ((tid >> 1) * 4 + h) + (tid & 1)];
        __syncthreads();
        if (tid == 0) { float m = 0.f;
            for (int c = 0; c < 64; ++c) { const float bl = tmp[2 * c], gm = tmp[2 * c + 1]; if (sub == 0) MST[c * 4 + h] = m;
                const float mn = fmaxf(bl + m, gm); dec[c] = __expf(bl + m - mn); scl[c] = __expf(gm - mn); m = mn; } }
        __syncthreads();
        if (tid < 256) { const int idx = sub * 256 + tid; float st = 0.f;
            for (int c = 0; c < 64; ++c) { const size_t o = (size_t)(c * 4 + h) * 16384 + idx; CT[o] = st; st = dec[c] * st + scl[c] * UT[o]; } }
        else if (sub == 1 && tid < 384) { const int d = tid - 256; float st = 0.f;
            for (int c = 0; c < 64; ++c) { const size_t o = (size_t)(c * 4 + h) * 128 + d; NST[o] = st; st = dec[c] * st + scl[c] * NLOC[o]; } }
    }
}

__device__ __forceinline__ void mlstm_out(LAS unsigned char* lds, const bf16* P, const float* gates, const float* CT, const float* NST, const float* MST, const float* gain, bf16* YC, int G, int bid, int tid) {
    asm volatile("" : "+v"(tid));
    const int lane = tid & 63, w = __builtin_amdgcn_readfirstlane(tid >> 6), fr = lane & 15, fq = lane >> 4;
    LAS bf16* Ks = (LAS bf16*)lds;
    LAS bf16* Vt = (LAS bf16*)(lds + 34816);
    LAS bf16* Cb = (LAS bf16*)(lds + 69632);
    LAS float* lf_s = (LAS float*)(lds + 108800); LAS float* a_s = lf_s + 128; LAS float* b_s = lf_s + 256; LAS float* M_s = lf_s + 384; LAS float* wi_s = lf_s + 512; LAS float* em_s = lf_s + 640;
    for (int u = bid; u < 256; u += G) {
        const int c = u >> 2, h = u & 3, tb = 128 * c;
        __syncthreads();
        float ig = 0.f;
        if (tid < 128) { const float fp = gates[(size_t)(tb + tid) * 8 + 4 + h]; lf_s[tid] = -softplus_f(-fp); ig = gates[(size_t)(tb + tid) * 8 + h]; }
        __syncthreads();
        float bme = 0.f;
        if (tid < 128) { for (int j = 0; j <= tid; ++j) bme += lf_s[j]; b_s[tid] = bme; a_s[tid] = ig - bme; }
        __syncthreads();
        if (tid < 128) { float pm = -3.0e38f; for (int j = 0; j <= tid; ++j) pm = fmaxf(pm, a_s[j]);
            const float m = MST[u], M = fmaxf(m, pm); M_s[tid] = M; wi_s[tid] = __expf(m - M); em_s[tid] = __expf(-(bme + M)); }
#pragma unroll
        for (int i = 0; i < 4; ++i) { const int pp = tid + 512 * i, s = pp >> 4, c16 = pp & 15;
            *(LAS v4u*)(Ks + s * 136 + c16 * 8) = *(const v4u*)(P + (size_t)(tb + s) * NPROJ + PC_MK + h * HDIM + c16 * 8); }
#pragma unroll
        for (int i = 0; i < 4; ++i) { const int pp = tid + 512 * i, s = pp & 127, c16 = pp >> 7;
            const v4u vv = *(const v4u*)(P + (size_t)(tb + s) * NPROJ + PC_MV + h * HDIM + c16 * 8);
            LAS bf16* dv = Vt + (c16 * 8) * 136 + s;
            dv[0 * 136] = (bf16)(vv.x & 0xffffu); dv[1 * 136] = (bf16)(vv.x >> 16); dv[2 * 136] = (bf16)(vv.y & 0xffffu); dv[3 * 136] = (bf16)(vv.y >> 16);
            dv[4 * 136] = (bf16)(vv.z & 0xffffu); dv[5 * 136] = (bf16)(vv.z >> 16); dv[6 * 136] = (bf16)(vv.w & 0xffffu); dv[7 * 136] = (bf16)(vv.w >> 16); }
        { const float* ct = CT + (size_t)u * 16384;
#pragma unroll
          for (int i = 0; i < 8; ++i) { const int q = tid + 512 * i, row = q >> 5, c4 = q & 31; const f32x4 v = *(const f32x4*)(ct + row * 128 + c4 * 4);
              v2u o; o.x = pk2(v.x, v.y); o.y = pk2(v.z, v.w); *(LAS v2u*)(Cb + row * 136 + c4 * 4) = o; }
          if (tid < 128) Cb[128 * 136 + tid] = (bf16)f2bf(NST[(size_t)u * 128 + tid]);
#pragma unroll
          for (int i = 0; i < 4; ++i) { const int q = tid + 512 * i; if (q < 15 * 128) Cb[(129 + (q >> 7)) * 136 + (q & 127)] = (bf16)0; } }
        bf16x8 qf[4];
        { const bf16* qrow = P + (size_t)(tb + 16 * w + fr) * NPROJ + PC_MQ + h * HDIM + 8 * fq;
#pragma unroll
          for (int ks = 0; ks < 4; ++ks) qf[ks] = *(const bf16x8*)(qrow + 32 * ks); }
        __syncthreads();
        f32x4 sa[8];
#pragma unroll
        for (int nt = 0; nt < 8; ++nt) sa[nt] = (f32x4){0.f, 0.f, 0.f, 0.f};
#pragma unroll
        for (int ks = 0; ks < 4; ++ks) {
#pragma unroll
            for (int nt = 0; nt < 8; ++nt) { const bf16x8 kf = *(const LAS bf16x8*)(Ks + (16 * nt + fr) * 136 + 32 * ks + 8 * fq); sa[nt] = MFMA16(qf[ks], kf, sa[nt]); } }
        float Mr[4], den[4];
#pragma unroll
        for (int r = 0; r < 4; ++r) { Mr[r] = M_s[16 * w + 4 * fq + r]; den[r] = 0.f; }
#pragma unroll
        for (int nt = 0; nt < 8; ++nt) { const int s = 16 * nt + fr; const float a = a_s[s];
#pragma unroll
            for (int r = 0; r < 4; ++r) { const int t = 16 * w + 4 * fq + r; const float wgt = (s <= t) ? __expf(a - Mr[r]) : 0.f; const float v = sa[nt][r] * QK_SCALE * wgt; sa[nt][r] = v; den[r] += v; } }
#pragma unroll
        for (int r = 0; r < 4; ++r) den[r] = red16_sum(den[r]);
        __syncthreads();
#pragma unroll
        for (int nt = 0; nt < 8; ++nt)
#pragma unroll
            for (int r = 0; r < 4; ++r) Ks[(16 * w + 4 * fq + r) * 136 + 16 * nt + fr] = (bf16)f2bf(sa[nt][r]);
        LDS_WAIT();
        f32x4 na[8];
#pragma unroll
        for (int nt = 0; nt < 8; ++nt) na[nt] = (f32x4){0.f, 0.f, 0.f, 0.f};
#pragma unroll
        for (int ks = 0; ks < 4; ++ks) { const bf16x8 pf = *(const LAS bf16x8*)(Ks + (16 * w + fr) * 136 + 32 * ks + 8 * fq);
#pragma unroll
            for (int nt = 0; nt < 8; ++nt) { const bf16x8 vf = *(const LAS bf16x8*)(Vt + (16 * nt + fr) * 136 + 32 * ks + 8 * fq); na[nt] = MFMA16(pf, vf, na[nt]); } }
        float wi[4], qn[4];
        { f32x4 c8 = (f32x4){0.f, 0.f, 0.f, 0.f};
#pragma unroll
          for (int ks = 0; ks < 4; ++ks) { const bf16x8 cf = *(const LAS bf16x8*)(Cb + (128 + fr) * 136 + 32 * ks + 8 * fq); c8 = MFMA16(qf[ks], cf, c8); }
#pragma unroll
          for (int r = 0; r < 4; ++r) { wi[r] = wi_s[16 * w + 4 * fq + r]; qn[r] = __shfl(c8[r], lane & 48); } }
#pragma unroll
        for (int nt = 0; nt < 8; ++nt) { f32x4 cc = (f32x4){0.f, 0.f, 0.f, 0.f};
#pragma unroll
            for (int ks = 0; ks < 4; ++ks) { const bf16x8 cf = *(const LAS bf16x8*)(Cb + (16 * nt + fr) * 136 + 32 * ks + 8 * fq); cc = MFMA16(qf[ks], cf, cc); }
#pragma unroll
            for (int r = 0; r < 4; ++r) na[nt][r] += wi[r] * cc[r]; }
#pragma unroll
        for (int r = 0; r < 4; ++r) { const int t = 16 * w + 4 * fq + r;
            const float dn = den[r] + wi[r] * qn[r]; const float inv = 1.0f / fmaxf(fabsf(dn), em_s[t]);
            float ssq = 0.f;
#pragma unroll
            for (int nt = 0; nt < 8; ++nt) { const float hv = na[nt][r] * inv; na[nt][r] = hv; ssq += hv * hv; }
            ssq = red16_sum(ssq); const float rn = rsqrtf(ssq * (1.f / 128.f) + NORM_EPS);
            const bf16* orow = P + (size_t)(tb + t) * NPROJ + PC_MO + h * HDIM + fr; bf16* yrow = YC + (size_t)(tb + t) * DM + 512 + h * HDIM + fr; const float* grow = gain + h * HDIM + fr;
#pragma unroll
            for (int nt = 0; nt < 8; ++nt) { const float op = bf2f(orow[16 * nt]);
                const float ov = na[nt][r] * rn * grow[16 * nt] / (1.f + __expf(-op));
                yrow[16 * nt] = (bf16)f2bf(ov); }
            asm volatile("" ::: "memory"); }
    }
}

struct Args { Ptrs p; int ph_lo, ph_hi; };
constexpr int N_PHASES = 1 + NLAYER * 12;
__global__ void __launch_bounds__(NWAVES * 64, 2) fwd_kernel(Args args) {
    extern __shared__ __attribute__((aligned(16))) unsigned char lds_raw[];
    LAS unsigned char* lds = (LAS unsigned char*)lds_raw;
    const Ptrs& p = args.p;
    const int tid = threadIdx.x, lane = tid & 63, wave = __builtin_amdgcn_readfirstlane(tid >> 6);
    const int G = gridDim.x, bid = blockIdx.x;
    const int vcu = (G % 8 == 0) ? (bid % 8) * (G / 8) + bid / 8 : bid;
    const int gw = vcu * NWAVES + wave, NGW = G * NWAVES;
    unsigned char* ws = p.ws;
    for (int u = tid; u < (LDS_BYTES - LDSCTL_OFF) / 4; u += NWAVES * 64) ((LAS unsigned*)(lds + LDSCTL_OFF))[u] = 0u;
    __syncthreads();
    volatile LAS unsigned* MISC = (volatile LAS unsigned*)(lds + MISC_OFF);
    XcdBarrier bar = xcd_barrier_post((unsigned*)(ws + WS_CTL) + CW_BAR, MISC + 8);
    const int lo = args.ph_lo, hi = args.ph_hi;
    int pid = 0;
#define IN_PH() (lo <= pid && pid < hi)
#define SEAM() do { if (lo <= pid && pid + 1 < hi) xcd_barrier(bar); ++pid; } while (0)

    bf16* Hb = (bf16*)(ws + WS_H); bf16* ACT = (bf16*)(ws + WS_ACT); float* Yb = (float*)(ws + WS_Y); bf16* YC = (bf16*)(ws + WS_YCAT);
    float* gates = (float*)(ws + WS_GATES);

    if (IN_PH()) prologue(p, lds, gw, NGW, wave, lane);
    SEAM();

    for (int sb = 0; sb < 2 * NLAYER; ++sb) {
        const int l = sb >> 1, second = sb & 1;
        unsigned char* wl = ws + WS_W + (size_t)l * WL_STRIDE;
        const float* gl = p.gains + (size_t)l * 6 * DM;
        if (IN_PH()) { pg8::Gemm g{Hb, (const bf16*)(wl + (second ? WL_GU2 : WL_GU1)), SEQ, 2 * DFF, DM}; pg8::StaticOrder S; S.init(SEQ, 2 * DFF, G, bid);
            pg8::EpiSwiglu E{ACT, DFF}; pg8::gemm_phase<pg8::EpiSwiglu, pg8::StaticOrder, true, true>(lds, g, S, E); }
        SEAM();
        if (IN_PH()) { pg8::Gemm g{ACT, (const bf16*)(wl + (second ? WL_D2 : WL_D1)), SEQ, DM, DFF}; pg8::StaticOrder S; S.init(SEQ, DM, G, bid);
            pg8::EpiF32 E{Yb, DM}; pg8::gemm_phase<pg8::EpiF32, pg8::StaticOrder, true, true>(lds, g, S, E); }
        SEAM();
        if (IN_PH()) {
            const float* gpost = gl + (second ? 5 : 1) * DM;
            const float* gpre = second ? (l + 1 < NLAYER ? gl + 6 * DM : nullptr) : gl + 2 * DM;
            thin_phase(Yb, p.out, Hb, 0.5f, gpost, gpre, second ? nullptr : (const float*)(ws + WS_WG) + (size_t)l * 8 * DM, p.i_bias + l * 4, p.f_bias + l * 4, gates, gw, NGW, lane); }
        SEAM();
        if (!second) {
            if (IN_PH()) { pg8::Gemm g{Hb, (const bf16*)(wl + WL_IN), SEQ, NPROJ, DM}; pg8::StaticOrder S; S.init(SEQ, NPROJ, G, bid);
                pg8::EpiBf16 E{ACT, NPROJ}; pg8::gemm_phase<pg8::EpiBf16, pg8::StaticOrder, true, true>(lds, g, S, E); }
            SEAM();
            if (IN_PH()) {
                mlstm_local(lds, ACT, gates, (float*)(ws + WS_UT), (float*)(ws + WS_NLOC), (float*)(ws + WS_SCAL), G, bid, tid);
                __syncthreads();
                attn_phase(lds, ACT, YC, G, bid, tid);
                mix_elem(ACT, YC, p.conv_w + (size_t)l * 3 * 512, vcu * NWAVES * 64 + tid, G * NWAVES * 64); }
            SEAM();
            if (IN_PH()) mlstm_scan(lds, (const float*)(ws + WS_UT), (float*)(ws + WS_CT), (const float*)(ws + WS_NLOC), (float*)(ws + WS_NST), (const float*)(ws + WS_SCAL), (float*)(ws + WS_MST), G, bid, tid);
            SEAM();
            if (IN_PH()) mlstm_out(lds, ACT, gates, (const float*)(ws + WS_CT), (const float*)(ws + WS_NST), (const float*)(ws + WS_MST), p.head_gain + l * 512, YC, G, bid, tid);
            SEAM();
            if (IN_PH()) { pg8::Gemm g{YC, (const bf16*)(wl + WL_OUT), SEQ, DM, DM}; pg8::StaticOrder S; S.init(SEQ, DM, G, bid);
                pg8::EpiF32 E{Yb, DM}; pg8::gemm_phase<pg8::EpiF32, pg8::StaticOrder, true, true>(lds, g, S, E); }
            SEAM();
            if (IN_PH()) thin_phase(Yb, p.out, Hb, 1.0f, gl + 3 * DM, gl + 4 * DM, nullptr, nullptr, nullptr, gates, gw, NGW, lane);
            SEAM();
        }
    }
#undef IN_PH
#undef SEAM
}

extern "C" void kernel_launch(void* const* d_in, const int* in_sizes, int n_in, void* d_out, int out_size, void* d_ws, size_t ws_size, hipStream_t stream) {
    static int grid = 0;
    if (grid == 0) {
        if (n_in != 16 || in_sizes[0] != SEQ * DM || out_size != SEQ * DM || ws_size < WS_END) {
            fprintf(stderr, "kernel_launch: unexpected shapes (n_in %d, in0 %d, out %d, ws %zu; need ws >= %zu); nothing launched\n", n_in, n_in > 0 ? in_sizes[0] : -1, out_size, ws_size, (size_t)WS_END); grid = -1; return; }
        int dev = 0, cus = 0, per_cu = 0;
        if (hipGetDevice(&dev) != hipSuccess || hipDeviceGetAttribute(&cus, hipDeviceAttributeMultiprocessorCount, dev) != hipSuccess) { fprintf(stderr, "kernel_launch: device query failed\n"); grid = -1; return; }
        if (hipFuncSetAttribute((const void*)fwd_kernel, hipFuncAttributeMaxDynamicSharedMemorySize, LDS_BYTES) != hipSuccess) { fprintf(stderr, "kernel_launch: hipFuncSetAttribute failed\n"); grid = -1; return; }
        if (hipOccupancyMaxActiveBlocksPerMultiprocessor(&per_cu, (const void*)fwd_kernel, NWAVES * 64, LDS_BYTES) != hipSuccess || per_cu < 1)
            fprintf(stderr, "kernel_launch: note: occupancy query reports %d workgroups per CU\n", per_cu);
        (void)hipGetLastError();
        grid = cus;
    }
    if (grid < 0) return;
    if (hipMemsetAsync((char*)d_ws + WS_CTL, 0, CTL_ZERO_BYTES, stream) != hipSuccess) { fprintf(stderr, "kernel_launch: memset failed\n"); return; }
    Args a{};
    a.p.x = (const float*)d_in[0]; a.p.w_in = (const float*)d_in[1]; a.p.w_out = (const float*)d_in[2]; a.p.conv_w = (const float*)d_in[3]; a.p.pool_w = (const float*)d_in[4];
    a.p.pool_scale = (const float*)d_in[5]; a.p.i_bias = (const float*)d_in[6]; a.p.f_bias = (const float*)d_in[7]; a.p.head_gain = (const float*)d_in[8];
    a.p.g1 = (const float*)d_in[9]; a.p.u1 = (const float*)d_in[10]; a.p.d1 = (const float*)d_in[11]; a.p.g2 = (const float*)d_in[12]; a.p.u2 = (const float*)d_in[13]; a.p.d2 = (const float*)d_in[14];
    a.p.gains = (const float*)d_in[15]; a.p.out = (float*)d_out; a.p.ws = (unsigned char*)d_ws;
    a.ph_lo = 0; a.ph_hi = N_PHASES;
    hipLaunchKernelGGL(fwd_kernel, dim3(grid), dim3(NWAVES * 64), LDS_BYTES, stream, a);
    const hipError_t le = hipPeekAtLastError();
    if (le != hipSuccess) fprintf(stderr, "kernel_launch: launch failed: %s\n", hipGetErrorName(le));
}
```
